# Optimizing an MI355X kernel written in HIP

```python
import jax, jax.numpy as jnp
from jax import lax
import numpy as np

D_MODEL = 1024
BATCH = 2
SEQ = 8192
DEPTH = 1
DEC_BATCH = 32
DEC_SEQ = 32
PAST_LEN = 4096

CHUNK = 64
MIX_WIDTH = D_MODEL
GLA_WIDTH = MIX_WIDTH // 2
GLA_HEADS = 4
GLA_DV = GLA_WIDTH // GLA_HEADS
GLA_DK = GLA_DV // 2
GLA_KEY_WIDTH = GLA_HEADS * GLA_DK
GLA_RANK = 16
GLA_GATE_TEMP = 16.0
GMLP_WIDTH = MIX_WIDTH - GLA_WIDTH
GMLP_GROUPS = 4
GMLP_GROUP_DIM = GMLP_WIDTH // GMLP_GROUPS
GMLP_CHUNK = 128
D_FF = 4 * D_MODEL
N_IN = 2 * GLA_KEY_WIDTH + 2 * GLA_WIDTH + GLA_RANK + 2 * GMLP_WIDTH
DN_ALPHA = (2 * DEPTH) ** 0.25
DN_BETA = (8 * DEPTH) ** -0.25
LN_EPS = 1e-5
RMS_EPS = 1e-6

kernel_name = "hybrid_gla_gmlp_streaming_encoder_step"


def layer_norm(x, g, b):
    xf = x.astype(jnp.float32)
    mu = jnp.mean(xf, axis=-1, keepdims=True)
    var = jnp.mean(jnp.square(xf - mu), axis=-1, keepdims=True)
    y = (xf - mu) * lax.rsqrt(var + LN_EPS) * g.astype(jnp.float32) + b.astype(jnp.float32)
    return y.astype(x.dtype)


def gla_block(S, q, k, v, g):
    C = q.shape[2]
    b = jnp.cumsum(g, axis=2)
    o_inter = jnp.einsum('bhid,bhde->bhie', q * jnp.exp(b), S)
    causal = jnp.tril(jnp.ones((C, C), dtype=bool))
    diff = b[:, :, :, None, :] - b[:, :, None, :, :]
    decay = jnp.exp(jnp.where(causal[None, None, :, :, None], diff, -jnp.inf))
    att = jnp.einsum('bhid,bhjd,bhijd->bhij', q, k, decay)
    o = o_inter + jnp.einsum('bhij,bhje->bhie', att, v)
    b_last = b[:, :, -1:, :]
    S_new = jnp.exp(b_last[:, :, 0, :])[..., None] * S + jnp.einsum(
        'bhjd,bhje->bhde', k * jnp.exp(b_last - b), v)
    return S_new, o


def token_mixers(h, s0, w_in, w_gate2, b_gate2, gla_norm_g, gmlp_ln_g, gmlp_ln_b, w_spatial, b_spatial):
    Bn, T, _ = h.shape
    f32 = jnp.float32
    proj = h @ w_in
    o1 = GLA_KEY_WIDTH
    o2 = o1 + GLA_KEY_WIDTH
    o3 = o2 + GLA_WIDTH
    o4 = o3 + GLA_WIDTH
    o5 = o4 + GLA_RANK
    o6 = o5 + GMLP_WIDTH
    q, k, v, r, glr, zu, zv = jnp.split(proj, [o1, o2, o3, o4, o5, o6], axis=-1)

    q = q.reshape(Bn, T, GLA_HEADS, GLA_DK).astype(f32) * (GLA_DK ** -0.5)
    k = k.reshape(Bn, T, GLA_HEADS, GLA_DK).astype(f32)
    v = v.reshape(Bn, T, GLA_HEADS, GLA_DV).astype(f32)
    glog = jax.nn.log_sigmoid((glr @ w_gate2 + b_gate2).astype(f32)) / GLA_GATE_TEMP
    glog = glog.reshape(Bn, T, GLA_HEADS, GLA_DK)
    c = min(T, CHUNK)
    n = T // c

    def to_blocks(a):
        return a.reshape(Bn, n, c, GLA_HEADS, a.shape[-1]).transpose(1, 0, 3, 2, 4)

    s_fin, o = lax.scan(lambda S, xs: gla_block(S, *xs), s0.astype(f32),
                        (to_blocks(q), to_blocks(k), to_blocks(v), to_blocks(glog)))
    o = o.transpose(1, 0, 3, 2, 4).reshape(Bn, T, GLA_HEADS, GLA_DV)
    o = o * lax.rsqrt(jnp.mean(jnp.square(o), axis=-1, keepdims=True) + RMS_EPS) * gla_norm_g.astype(f32)
    o_gla = o.reshape(Bn, T, GLA_WIDTH).astype(h.dtype) * jax.nn.silu(r)

    zu = jax.nn.gelu(zu, approximate=False)
    zv = layer_norm(jax.nn.gelu(zv, approximate=False), gmlp_ln_g, gmlp_ln_b)
    L = min(T, GMLP_CHUNK)
    m = T // L
    mask = jnp.tril(jnp.ones((L, L), dtype=bool))
    ws = jnp.where(mask[None], w_spatial[:, :L, :L], 0.0)
    vb = zv.reshape(Bn, m, L, GMLP_GROUPS, GMLP_GROUP_DIM)
    s = jnp.einsum('gij,bmjgc->bmigc', ws, vb) + b_spatial[:, :L].T[None, None, :, :, None]
    o_gmlp = zu * s.reshape(Bn, T, GMLP_WIDTH)

    mix = jnp.concatenate([o_gla, o_gmlp], axis=-1)
    return mix, s_fin.astype(s0.dtype), zv


def trunk_layer(x, c, s0, w_ada, b_ada, w_in, w_gate2, b_gate2, gla_norm_g, gmlp_ln_g, gmlp_ln_b,
                w_spatial, b_spatial, w_o, b_o, ln1_g, ln1_b, w_up, b_up, w_down, b_down, ln2_g, ln2_b):
    mod = jax.nn.silu(c) @ w_ada + b_ada
    shift1, scale1, gate1, shift2, scale2, gate2 = [t[:, None, :] for t in jnp.split(mod, 6, axis=-1)]
    h = x * (1.0 + scale1) + shift1
    mix, s_fin, v_rows = token_mixers(h, s0, w_in, w_gate2, b_gate2, gla_norm_g, gmlp_ln_g, gmlp_ln_b,
                                      w_spatial, b_spatial)
    x = layer_norm(DN_ALPHA * x + (1.0 + gate1) * (mix @ w_o + b_o), ln1_g, ln1_b)
    h2 = x * (1.0 + scale2) + shift2
    f = jnp.square(jax.nn.relu(h2 @ w_up + b_up)) @ w_down + b_down
    x = layer_norm(DN_ALPHA * x + (1.0 + gate2) * f, ln2_g, ln2_b)
    return x, s_fin, v_rows


def setup_inputs(seed: int = 0) -> dict:
    key = jax.random.key(seed)
    ks = jax.random.split(key, 32)
    nrm = lambda k, shape, s: jax.random.normal(k, shape, jnp.float32) * s
    D = D_MODEL
    return {
        "x_prompt": nrm(ks[0], (BATCH, SEQ, D), 1.0),
        "x_sample": nrm(ks[1], (DEC_BATCH, DEC_SEQ, D), 1.0),
        "state_gla": nrm(ks[2], (DEPTH, DEC_BATCH, GLA_HEADS, GLA_DK, GLA_DV), 0.5),
        "c_prompt": nrm(ks[3], (BATCH, D), 1.0),
        "c_sample": nrm(ks[4], (DEC_BATCH, D), 1.0),
        "ln_in_g": 1.0 + nrm(ks[5], (D,), 0.02),
        "ln_in_b": nrm(ks[6], (D,), 0.02),
        "w_ada": nrm(ks[7], (DEPTH, D, 6 * D), 0.1 * D ** -0.5),
        "b_ada": nrm(ks[8], (DEPTH, 6 * D), 0.01),
        "w_in": nrm(ks[9], (DEPTH, D, N_IN), D ** -0.5),
        "w_gate2": nrm(ks[10], (DEPTH, GLA_RANK, GLA_KEY_WIDTH), GLA_RANK ** -0.5),
        "b_gate2": nrm(ks[11], (DEPTH, GLA_KEY_WIDTH), 0.1),
        "gla_norm_g": 1.0 + nrm(ks[12], (DEPTH, GLA_DV), 0.02),
        "gmlp_ln_g": 1.0 + nrm(ks[13], (DEPTH, GMLP_WIDTH), 0.02),
        "gmlp_ln_b": nrm(ks[14], (DEPTH, GMLP_WIDTH), 0.02),
        "w_spatial": nrm(ks[15], (DEPTH, GMLP_GROUPS, GMLP_CHUNK, GMLP_CHUNK), 0.5 * GMLP_CHUNK ** -0.5),
        "b_spatial": 1.0 + nrm(ks[16], (DEPTH, GMLP_GROUPS, GMLP_CHUNK), 0.02),
        "w_o": nrm(ks[17], (DEPTH, MIX_WIDTH, D), DN_BETA * MIX_WIDTH ** -0.5),
        "b_o": nrm(ks[18], (DEPTH, D), 0.01),
        "ln1_g": 1.0 + nrm(ks[19], (DEPTH, D), 0.02),
        "ln1_b": nrm(ks[20], (DEPTH, D), 0.02),
        "w_up": nrm(ks[21], (DEPTH, D, D_FF), D ** -0.5),
        "b_up": nrm(ks[22], (DEPTH, D_FF), 0.01),
        "w_down": nrm(ks[23], (DEPTH, D_FF, D), DN_BETA * D_FF ** -0.5),
        "b_down": nrm(ks[24], (DEPTH, D), 0.01),
        "ln2_g": 1.0 + nrm(ks[25], (DEPTH, D), 0.02),
        "ln2_b": nrm(ks[26], (DEPTH, D), 0.02),
    }


def reference(x_prompt, x_sample, state_gla, c_prompt, c_sample, ln_in_g, ln_in_b, w_ada, b_ada, w_in,
              w_gate2, b_gate2, gla_norm_g, gmlp_ln_g, gmlp_ln_b, w_spatial, b_spatial, w_o, b_o,
              ln1_g, ln1_b, w_up, b_up, w_down, b_down, ln2_g, ln2_b):
    xp = layer_norm(x_prompt, ln_in_g, ln_in_b)
    xs = layer_norm(x_sample, ln_in_g, ln_in_b)
    s_zero = jnp.zeros((x_prompt.shape[0], GLA_HEADS, GLA_DK, GLA_DV), state_gla.dtype)
    new_p, new_s, new_v = [], [], []
    for l in range(DEPTH):
        params = (w_ada[l], b_ada[l], w_in[l], w_gate2[l], b_gate2[l], gla_norm_g[l], gmlp_ln_g[l],
                  gmlp_ln_b[l], w_spatial[l], b_spatial[l], w_o[l], b_o[l], ln1_g[l], ln1_b[l],
                  w_up[l], b_up[l], w_down[l], b_down[l], ln2_g[l], ln2_b[l])
        xp, sp, _ = trunk_layer(xp, c_prompt, s_zero, *params)
        xs, ss, vs = trunk_layer(xs, c_sample, state_gla[l], *params)
        new_p.append(sp)
        new_s.append(ss)
        new_v.append(vs)
    new_state_gla_prompt = jnp.stack(new_p)
    new_state_gla_sample = jnp.stack(new_s)
    new_gmlp_v_sample = jnp.stack(new_v)
    return (xp, xs, new_state_gla_prompt, new_state_gla_sample, new_gmlp_v_sample)
```

```cpp
#include <hip/hip_runtime.h>
#include <hip/hip_cooperative_groups.h>
#include <cstdio>
namespace cg = cooperative_groups;

#ifndef MULTI_LAUNCH
#define MULTI_LAUNCH 1
#endif

#define LAS __attribute__((address_space(3)))
typedef unsigned short bf16_t;
typedef short bf16x8 __attribute__((ext_vector_type(8)));
typedef float f32x4 __attribute__((ext_vector_type(4)));
typedef float f32x2 __attribute__((ext_vector_type(2)));
typedef unsigned u32x4 __attribute__((ext_vector_type(4)));
typedef unsigned u32x2 __attribute__((ext_vector_type(2)));

constexpr int D = 1024, FF = 4096, MP = 16384, MS = 1024, MTOT = MP + MS, SEQ = 8192;
constexpr int NPROJ = 2816;
constexpr int PP = 2560;
constexpr int NSLOT = 1024 + 128;
constexpr float LN_EPS = 1e-5f, RMS_EPS = 1e-6f, DN_ALPHA = 1.189207115002721f;
constexpr int NPHASE = 11;
constexpr int LDS_BYTES = 147456;

constexpr size_t MiB = 1u << 20;
constexpr size_t WS_MOD = 1 * MiB, WS_WIN = 2 * MiB, WS_WO = 8 * MiB, WS_WUP = 10 * MiB, WS_WDN = 18 * MiB;
constexpr size_t WS_GLR = 26 * MiB, WS_DVEC = 28 * MiB;
constexpr size_t WS_H = 32 * MiB;
constexpr size_t WS_P = 66 * MiB;
constexpr size_t WS_MIX = 160 * MiB;
constexpr size_t WS_AS = 194 * MiB;
constexpr size_t WS_U = 66 * MiB;
constexpr size_t WS_END = 256 * MiB;
static_assert(WS_AS + (size_t)NSLOT * 8192 * 4 <= WS_END && WS_U + (size_t)MTOT * FF * 2 <= WS_END, "ws map");

constexpr size_t OUT_Y = 0, OUT_SP = (size_t)MTOT * D, OUT_SS = OUT_SP + 2 * 4 * 64 * 128, OUT_V = OUT_SS + 32 * 4 * 64 * 128;

struct Params {
    const float *x_prompt, *x_sample, *state_gla, *c_prompt, *c_sample, *ln_in_g, *ln_in_b, *w_ada, *b_ada, *w_in, *w_gate2, *b_gate2,
        *gla_norm_g, *gmlp_ln_g, *gmlp_ln_b, *w_spatial, *b_spatial, *w_o, *b_o, *ln1_g, *ln1_b, *w_up, *b_up, *w_down, *b_down, *ln2_g, *ln2_b;
    float* out; unsigned char* ws;
    int lo, hi;
};

__device__ __forceinline__ unsigned cvt_pk_bf16(float lo, float hi) { unsigned r; asm volatile("v_cvt_pk_bf16_f32 %0, %1, %2" : "=v"(r) : "v"(lo), "v"(hi)); return r; }
__device__ __forceinline__ bf16_t f2bf(float f) { return (bf16_t)(cvt_pk_bf16(f, 0.f) & 0xffffu); }
__device__ __forceinline__ float bflo(unsigned w) { return __uint_as_float(w << 16); }
__device__ __forceinline__ float bfhi(unsigned w) { return __uint_as_float(w & 0xffff0000u); }
__device__ __forceinline__ float bf2f(bf16_t b) { return __uint_as_float(((unsigned)b) << 16); }
__device__ __forceinline__ float wave_sum(float v) {
#pragma unroll
    for (int o = 1; o < 64; o <<= 1) v += __shfl_xor(v, o);
    return v;
}
__device__ __forceinline__ int bidx_of_row(int row) { return row < MP ? (row >> 13) : 2 + ((row - MP) >> 5); }
__device__ __forceinline__ float silu_f(float x) { return x / (1.0f + __expf(-x)); }
typedef float f32x2v __attribute__((ext_vector_type(2)));
__device__ __forceinline__ f32x2v gelu_pk(f32x2v v) {
    const f32x2v av = __builtin_elementwise_abs(v), d = av * 0.2316418882f + 1.0f;
    f32x2v t; t.x = __builtin_amdgcn_rcpf(d.x); t.y = __builtin_amdgcn_rcpf(d.y);
    f32x2v q = t * 0.5307027145f + (-0.7265760135f); q = q * t + 0.7107068705f; q = q * t + (-0.142248368f); q = q * t + 0.127414796f; q = q * t;
    const f32x2v s = (v * v) * (-0.72134752044f);
    f32x2v e; e.x = __builtin_amdgcn_exp2f(s.x); e.y = __builtin_amdgcn_exp2f(s.y);
    const f32x2v m = v * (q * e), r = v - m;
    f32x2v o; o.x = v.x < 0.f ? m.x : r.x; o.y = v.y < 0.f ? m.y : r.y; return o;
}

namespace pg8 {
constexpr int BM = 256, BK = 64, HALF = 128, HTB = HALF * BK * 2, STAGE_BYTES = 8 * HTB, NXCD = 8, WGM = 8;
__device__ __forceinline__ int lds_byte(int r, int c) { const int st = (r >> 4) * 2 + (c >> 5), rr = r & 15, cc = c & 31, ob = rr * 64 + cc * 2; return st * 1024 + (ob ^ (((ob >> 9) & 1) << 5)); }
__device__ __forceinline__ void stage_rc(int b, int& R, int& C) { const int st = b / 1024, sb = b % 1024, swz = sb ^ (((sb >> 9) & 1) << 5); R = (st >> 1) * 16 + swz / 64; C = (st & 1) * 32 + (swz % 64) / 2; }
__device__ __forceinline__ int perm32(int rho) { const int n = rho >> 4, i = rho & 15; return 8 * (i >> 2) + 4 * n + (i & 3); }
struct Unit { int pm, pn; };
struct Gemm { const bf16_t* A; const bf16_t* Bt; int M, N, K; };
struct StaticOrder {
    int nM, nN, nwg, G, c;
    __device__ void init(int M, int N, int G_, int c_) { nM = M / BM; nN = N / BM; nwg = nM * nN; G = G_; c = c_; }
    __device__ bool next(int i, Unit& u) const {
        const long L = (long)i * G + c; if (L >= nwg) return false;
        int wgid = (int)L; { const int q = nwg / NXCD, r = nwg % NXCD, xcd = wgid % NXCD, off = wgid / NXCD; wgid = (xcd < r ? xcd * (q + 1) : r * (q + 1) + (xcd - r) * q) + off; }
        const int nig = WGM * nN, gid = wgid / nig, fm = gid * WGM, gsz = (nM - fm) < WGM ? (nM - fm) : WGM;
        u.pm = fm + ((wgid % nig) % gsz); u.pn = (wgid % nig) / gsz; return true;
    }
};
template <class Epi>
__device__ __forceinline__ void gemm_phase(LAS unsigned char* lds, const Gemm g, const StaticOrder& S, const Epi& E) {
    const int tid = threadIdx.x, wid = __builtin_amdgcn_readfirstlane(tid >> 6), lane = tid & 63, wr = wid >> 2, wc = wid & 3, fr = lane & 15, fq = lane >> 4;
    const int K = g.K, nt = K / BK;
    unsigned voffA[2], voffB[2];
#pragma unroll
    for (int i = 0; i < 2; ++i) { int R, C; stage_rc(tid * 16 + i * 8192, R, C); const int Rb = Epi::PERM ? ((R & ~31) + perm32(R & 31)) : R;
        voffA[i] = (unsigned)(R * K + C) * 2u; voffB[i] = (unsigned)(Rb * K + C) * 2u; }
    const size_t kstep = (size_t)(BK * 2);
    const size_t hstep = (size_t)HALF * K * 2;
    const size_t tstep = 2 * hstep;
    const unsigned ldsw = (unsigned)wid * 1024u;
    const int aoff = lds_byte(wr * 64 + fr, fq * 8), boff = lds_byte(wc * 32 + fr, fq * 8);
#define PG8_SA(b, h) (((b) * 2 + (h)) * HTB)
#define PG8_SB(b, h) ((4 + (b) * 2 + (h)) * HTB)
#define PG8_STAGE(bufoff, gbase, voff) do { _Pragma("unroll") for (int _i = 0; _i < 2; ++_i) \
        __builtin_amdgcn_global_load_lds((const unsigned*)((const char*)(gbase) + (voff)[_i]), (LAS unsigned*)(lds + (bufoff) + ldsw + _i * 8192), 16, 0, 0); } while (0)
#define PG8_LDA(dst, b, h) do { _Pragma("unroll") for (int m = 0; m < 4; ++m) _Pragma("unroll") for (int k = 0; k < 2; ++k) dst[m][k] = *(const LAS bf16x8*)(lds + PG8_SA(b, h) + aoff + m * 2048 + k * 1024); } while (0)
#define PG8_LDB(dst, b, h) do { _Pragma("unroll") for (int n = 0; n < 2; ++n) _Pragma("unroll") for (int k = 0; k < 2; ++k) dst[n][k] = *(const LAS bf16x8*)(lds + PG8_SB(b, h) + boff + n * 2048 + k * 1024); } while (0)
#define PG8_MMA(ai, bj, At, Bt) do { __builtin_amdgcn_s_setprio(1); _Pragma("unroll") for (int m = 0; m < 4; ++m) _Pragma("unroll") for (int n = 0; n < 2; ++n) _Pragma("unroll") for (int k = 0; k < 2; ++k) \
        acc[ai][bj][m][n] = __builtin_amdgcn_mfma_f32_16x16x32_bf16(Bt[n][k], At[m][k], acc[ai][bj][m][n], 0, 0, 0); __builtin_amdgcn_s_setprio(0); } while (0)
#define PG8_WAIT_V(n) asm volatile("s_waitcnt vmcnt(" #n ")" ::: "memory")
#define PG8_WAIT_L(n) asm volatile("s_waitcnt lgkmcnt(" #n ")" ::: "memory")
#define PG8_BAR __builtin_amdgcn_s_barrier()
#define PG8_SCHED __builtin_amdgcn_sched_barrier(0)
    Unit cur, nxt; int ui = 0;
    if (!S.next(0, cur)) return;
    f32x4 acc[2][2][4][2];
#pragma unroll
    for (int a = 0; a < 2; ++a)
#pragma unroll
        for (int b = 0; b < 2; ++b)
#pragma unroll
            for (int m = 0; m < 4; ++m)
#pragma unroll
                for (int n = 0; n < 2; ++n) acc[a][b][m][n] = (f32x4){0.f, 0.f, 0.f, 0.f};
    bf16x8 At[4][2], B0[2][2], B1[2][2];
    const char* cA = (const char*)g.A + (size_t)cur.pm * tstep; const char* cB = (const char*)g.Bt + (size_t)cur.pn * tstep;
    PG8_STAGE(PG8_SB(0, 0), cB, voffB); PG8_STAGE(PG8_SA(0, 0), cA, voffA); PG8_STAGE(PG8_SB(0, 1), cB + hstep, voffB); PG8_STAGE(PG8_SA(0, 1), cA + hstep, voffA);
    if (wr == 1) PG8_BAR;
    PG8_WAIT_V(4); PG8_BAR;
    PG8_STAGE(PG8_SB(1, 0), cB + kstep, voffB); PG8_STAGE(PG8_SA(1, 0), cA + kstep, voffA); PG8_STAGE(PG8_SB(1, 1), cB + hstep + kstep, voffB);
    PG8_WAIT_V(6); PG8_BAR;
    for (;;) {
        const bool has_next = S.next(ui + 1, nxt);
        const char* nA = has_next ? (const char*)g.A + (size_t)nxt.pm * tstep : cA; const char* nB = has_next ? (const char*)g.Bt + (size_t)nxt.pn * tstep : cB;
        for (int t = 0; t < nt; t += 2) {
            const bool last = (t == nt - 2);
            const char* a1 = cA + (size_t)(t + 1) * kstep;
            const char* a2 = last ? nA : cA + (size_t)(t + 2) * kstep; const char* b2 = last ? nB : cB + (size_t)(t + 2) * kstep;
            const char* a3 = a2 + kstep; const char* b3 = b2 + kstep;
            PG8_LDB(B0, 0, 0); PG8_SCHED; PG8_LDA(At, 0, 0); PG8_STAGE(PG8_SA(1, 1), a1 + hstep, voffA);
            PG8_WAIT_L(8); PG8_BAR; PG8_WAIT_L(0); PG8_MMA(0, 0, At, B0); PG8_BAR; PG8_SCHED;
            PG8_LDB(B1, 0, 1); PG8_STAGE(PG8_SB(0, 0), b2, voffB);
            PG8_BAR; PG8_WAIT_L(0); PG8_MMA(0, 1, At, B1); PG8_BAR;
            PG8_LDA(At, 0, 1); PG8_STAGE(PG8_SA(0, 0), a2, voffA);
            PG8_BAR; PG8_WAIT_L(0); PG8_MMA(1, 0, At, B0); PG8_BAR; PG8_SCHED;
            PG8_STAGE(PG8_SB(0, 1), b2 + hstep, voffB);
            PG8_WAIT_V(6); PG8_BAR; PG8_MMA(1, 1, At, B1); PG8_BAR;
            PG8_LDB(B0, 1, 0); PG8_SCHED; PG8_LDA(At, 1, 0); PG8_STAGE(PG8_SA(0, 1), a2 + hstep, voffA);
            PG8_WAIT_L(8); PG8_BAR; PG8_WAIT_L(0); PG8_MMA(0, 0, At, B0); PG8_BAR; PG8_SCHED;
            PG8_LDB(B1, 1, 1); PG8_STAGE(PG8_SB(1, 0), b3, voffB);
            PG8_BAR; PG8_WAIT_L(0); PG8_MMA(0, 1, At, B1); PG8_BAR;
            PG8_LDA(At, 1, 1); PG8_STAGE(PG8_SA(1, 0), a3, voffA);
            PG8_BAR; PG8_WAIT_L(0); PG8_MMA(1, 0, At, B0); PG8_BAR; PG8_SCHED;
            PG8_STAGE(PG8_SB(1, 1), b3 + hstep, voffB);
            PG8_WAIT_V(6); PG8_BAR; PG8_MMA(1, 1, At, B1); PG8_BAR;
        }
        E(acc, cur, wr, wc, fr, fq);
        if (!has_next) break;
#pragma unroll
        for (int a = 0; a < 2; ++a)
#pragma unroll
            for (int b = 0; b < 2; ++b)
#pragma unroll
                for (int m = 0; m < 4; ++m)
#pragma unroll
                    for (int n = 0; n < 2; ++n) acc[a][b][m][n] = (f32x4){0.f, 0.f, 0.f, 0.f};
        cur = nxt; cA = nA; cB = nB; ++ui;
    }
    PG8_WAIT_V(0);
    if (wr == 0) PG8_BAR;
    PG8_BAR;
#undef PG8_SA
#undef PG8_SB
#undef PG8_STAGE
#undef PG8_LDA
#undef PG8_LDB
#undef PG8_MMA
#undef PG8_WAIT_V
#undef PG8_WAIT_L
#undef PG8_BAR
#undef PG8_SCHED
}
}
typedef f32x4 AccT[2][2][4][2];

struct EpiProj {
    static constexpr bool PERM = true;
    bf16_t* P; float* glr;
    __device__ __forceinline__ void operator()(const AccT& acc, const pg8::Unit& u, int wr, int wc, int fr, int fq) const {
        const int row0 = u.pm * 256 + wr * 64 + fr, pn = u.pn;
        if (pn == 10) {
            if (wc == 0 && fq < 2) {
#pragma unroll
                for (int ai = 0; ai < 2; ++ai)
#pragma unroll
                    for (int m = 0; m < 4; ++m) { float* gp = glr + (size_t)(row0 + ai * 128 + m * 16) * 16 + 8 * fq;
                        *(f32x4*)gp = acc[ai][0][m][0]; *(f32x4*)(gp + 4) = acc[ai][0][m][1]; }
            }
            return;
        }
        const int col0 = pn * 256 + wc * 32 + 8 * fq;
        const int mode = pn == 0 ? 1 : (pn < 4 ? 0 : (pn < 6 ? 2 : 3));
#pragma unroll
        for (int ai = 0; ai < 2; ++ai)
#pragma unroll
            for (int m = 0; m < 4; ++m) { bf16_t* rowp = P + (size_t)(row0 + ai * 128 + m * 16) * PP + col0;
#pragma unroll
                for (int bj = 0; bj < 2; ++bj) { f32x4 v0 = acc[ai][bj][m][0], v1 = acc[ai][bj][m][1];
                    if (mode == 1) { v0 = v0 * 0.125f; v1 = v1 * 0.125f; }
                    else if (mode == 2) {
#pragma unroll
                        for (int j = 0; j < 4; ++j) { v0[j] = silu_f(v0[j]); v1[j] = silu_f(v1[j]); } }
                    else if (mode == 3) { f32x2v a = gelu_pk((f32x2v){v0[0], v0[1]}), b = gelu_pk((f32x2v){v0[2], v0[3]}), c = gelu_pk((f32x2v){v1[0], v1[1]}), d = gelu_pk((f32x2v){v1[2], v1[3]});
                        v0 = (f32x4){a.x, a.y, b.x, b.y}; v1 = (f32x4){c.x, c.y, d.x, d.y}; }
                    u32x4 w; w.x = cvt_pk_bf16(v0[0], v0[1]); w.y = cvt_pk_bf16(v0[2], v0[3]); w.z = cvt_pk_bf16(v1[0], v1[1]); w.w = cvt_pk_bf16(v1[2], v1[3]);
                    *(u32x4*)(rowp + bj * 128) = w; } }
    }
};
struct EpiUp {
    static constexpr bool PERM = true;
    bf16_t* U; const float* bias;
    __device__ __forceinline__ void operator()(const AccT& acc, const pg8::Unit& u, int wr, int wc, int fr, int fq) const {
        const int row0 = u.pm * 256 + wr * 64 + fr, col0 = u.pn * 256 + wc * 32 + 8 * fq;
        f32x4 bv[2][2];
#pragma unroll
        for (int bj = 0; bj < 2; ++bj)
#pragma unroll
            for (int n = 0; n < 2; ++n) bv[bj][n] = *(const f32x4*)(bias + col0 + bj * 128 + 4 * n);
#pragma unroll
        for (int ai = 0; ai < 2; ++ai)
#pragma unroll
            for (int m = 0; m < 4; ++m) { bf16_t* rowp = U + (size_t)(row0 + ai * 128 + m * 16) * FF + col0;
#pragma unroll
                for (int bj = 0; bj < 2; ++bj) { f32x4 v0 = acc[ai][bj][m][0] + bv[bj][0], v1 = acc[ai][bj][m][1] + bv[bj][1];
#pragma unroll
                    for (int j = 0; j < 4; ++j) { const float a = fmaxf(v0[j], 0.f), b = fmaxf(v1[j], 0.f); v0[j] = a * a; v1[j] = b * b; }
                    u32x4 w; w.x = cvt_pk_bf16(v0[0], v0[1]); w.y = cvt_pk_bf16(v0[2], v0[3]); w.z = cvt_pk_bf16(v1[0], v1[1]); w.w = cvt_pk_bf16(v1[2], v1[3]);
                    *(u32x4*)(rowp + bj * 128) = w; } }
    }
};
struct EpiRes {
    static constexpr bool PERM = false;
    float* Y; const float* bias; const float* gate;
    __device__ __forceinline__ void operator()(const AccT& acc, const pg8::Unit& u, int wr, int wc, int fr, int fq) const {
        const int row0 = u.pm * 256 + wr * 64 + fr, col0 = u.pn * 256 + wc * 32 + 4 * fq;
        f32x4 bv[2][2];
#pragma unroll
        for (int bj = 0; bj < 2; ++bj)
#pragma unroll
            for (int n = 0; n < 2; ++n) bv[bj][n] = *(const f32x4*)(bias + col0 + bj * 128 + n * 16);
#pragma unroll
        for (int ai = 0; ai < 2; ++ai)
#pragma unroll
            for (int m = 0; m < 4; ++m) { const int row = row0 + ai * 128 + m * 16; float* rowp = Y + (size_t)row * D + col0;
                const float* gp = gate + (size_t)bidx_of_row(row) * 6144 + col0;
#pragma unroll
                for (int bj = 0; bj < 2; ++bj)
#pragma unroll
                    for (int n = 0; n < 2; ++n) { const f32x4 gv = *(const f32x4*)(gp + bj * 128 + n * 16); const f32x4 y = *(const f32x4*)(rowp + bj * 128 + n * 16);
                        *(f32x4*)(rowp + bj * 128 + n * 16) = y * DN_ALPHA + (gv + 1.0f) * (acc[ai][bj][m][n] + bv[bj][n]); }
                asm volatile("" ::: "memory"); }
    }
};

__device__ __forceinline__ void p0_transpose_item(const float* W, int K, int N, bf16_t* WT, int nblk, bool remap, LAS float* scr, int item, int lane) {
    const int kb = item / nblk, nb = item % nblk, k0 = 64 * kb, n0 = 32 * nb;
    int nn = n0 + (lane & 31), src = nn;
    if (remap) src = nn < 1536 ? nn : (nn < 2560 ? nn + 16 : (nn < 2576 ? nn - 1024 : -1));
#pragma unroll 8
    for (int i = 0; i < 32; ++i) { const int kk = 2 * i + (lane >> 5); scr[kk * 33 + (lane & 31)] = src >= 0 ? W[(size_t)(k0 + kk) * N + src] : 0.f; }
    asm volatile("s_waitcnt lgkmcnt(0)" ::: "memory");
    const int c = lane & 7;
#pragma unroll
    for (int j = 0; j < 4; ++j) { const int n = (lane >> 3) + 8 * j; const LAS float* s = scr + (8 * c) * 33 + n;
        u32x4 o; o.x = cvt_pk_bf16(s[0 * 33], s[1 * 33]); o.y = cvt_pk_bf16(s[2 * 33], s[3 * 33]); o.z = cvt_pk_bf16(s[4 * 33], s[5 * 33]); o.w = cvt_pk_bf16(s[6 * 33], s[7 * 33]);
        *(u32x4*)(WT + (size_t)(n0 + n) * K + k0 + 8 * c) = o; }
    asm volatile("s_waitcnt lgkmcnt(0)" ::: "memory");
}
__device__ __forceinline__ void p0_mod_item(const Params& p, int item, LAS float* lds) {
    const int tid = threadIdx.x, lane = tid & 63, wave = tid >> 6, col = lane & 31, kg = wave * 2 + (lane >> 5), n0 = item * 32;
    float acc[34];
#pragma unroll
    for (int r = 0; r < 34; ++r) acc[r] = 0.f;
    for (int kh = 0; kh < 2; ++kh) {
        __syncthreads();
        for (int idx = tid; idx < 34 * 512; idx += 512) { const int r = idx >> 9, k = idx & 511; const float cv = r < 2 ? p.c_prompt[r * D + kh * 512 + k] : p.c_sample[(r - 2) * D + kh * 512 + k];
            lds[k * 36 + r] = cv / (1.0f + expf(-cv)); }
        __syncthreads();
#pragma unroll 4
        for (int kk = 0; kk < 32; ++kk) { const int k = kg * 32 + kk; const float w = p.w_ada[(size_t)(kh * 512 + k) * 6144 + n0 + col];
            const LAS f32x4* sp = (const LAS f32x4*)(lds + k * 36);
#pragma unroll
            for (int r4 = 0; r4 < 8; ++r4) { const f32x4 s = sp[r4]; acc[4 * r4] += s[0] * w; acc[4 * r4 + 1] += s[1] * w; acc[4 * r4 + 2] += s[2] * w; acc[4 * r4 + 3] += s[3] * w; }
            const f32x2 s2 = *(const LAS f32x2*)(lds + k * 36 + 32); acc[32] += s2[0] * w; acc[33] += s2[1] * w; }
    }
    __syncthreads();
#pragma unroll
    for (int r = 0; r < 34; ++r) lds[(kg * 34 + r) * 32 + col] = acc[r];
    __syncthreads();
    float* mod = (float*)(p.ws + WS_MOD);
    for (int idx = tid; idx < 34 * 32; idx += 512) { const int r = idx >> 5, c = idx & 31; float s = p.b_ada[n0 + c];
#pragma unroll
        for (int g = 0; g < 16; ++g) s += lds[(g * 34 + r) * 32 + c];
        mod[(size_t)r * 6144 + n0 + c] = s; }
    __syncthreads();
}
__device__ __forceinline__ void phase0(const Params& p, LAS unsigned char* lds) {
    const int tid = threadIdx.x, lane = tid & 63, wave = __builtin_amdgcn_readfirstlane(tid >> 6);
    if (blockIdx.x < 192) p0_mod_item(p, blockIdx.x, (LAS float*)lds);
    LAS float* scr = (LAS float*)(lds + wave * 8448);
    const int gw = blockIdx.x * 8 + wave, NGW = gridDim.x * 8;
    constexpr int I_IN = 16 * (NPROJ / 32), I_O = 16 * 32, I_UP = 16 * 128, I_DN = 64 * 32, NIT = I_IN + I_O + I_UP + I_DN;
    for (int it = gw; it < NIT; it += NGW) {
        int r = it;
        if (r < I_IN) { p0_transpose_item(p.w_in, D, 2576, (bf16_t*)(p.ws + WS_WIN), NPROJ / 32, true, scr, r, lane); continue; } r -= I_IN;
        if (r < I_O) { p0_transpose_item(p.w_o, D, D, (bf16_t*)(p.ws + WS_WO), 32, false, scr, r, lane); continue; } r -= I_O;
        if (r < I_UP) { p0_transpose_item(p.w_up, D, FF, (bf16_t*)(p.ws + WS_WUP), 128, false, scr, r, lane); continue; } r -= I_UP;
        p0_transpose_item(p.w_down, FF, D, (bf16_t*)(p.ws + WS_WDN), 32, false, scr, r, lane);
    }
}

template <int MODE>
__device__ __forceinline__ void ln_phase(const Params& p) {
    const int tid = threadIdx.x, lane = tid & 63, wave = tid >> 6;
    const float* gam = MODE == 0 ? p.ln_in_g : (MODE == 1 ? p.ln1_g : p.ln2_g);
    const float* bet = MODE == 0 ? p.ln_in_b : (MODE == 1 ? p.ln1_b : p.ln2_b);
    const float* mod = (const float*)(p.ws + WS_MOD);
    bf16_t* H = (bf16_t*)(p.ws + WS_H);
    f32x4 gv[4], bv[4];
#pragma unroll
    for (int j = 0; j < 4; ++j) { gv[j] = ((const f32x4*)gam)[lane + 64 * j]; bv[j] = ((const f32x4*)bet)[lane + 64 * j]; }
    for (int row = blockIdx.x * 8 + wave; row < MTOT; row += gridDim.x * 8) {
        float* yrow = p.out + OUT_Y + (size_t)row * D;
        const float* xin = MODE == 0 ? (row < MP ? p.x_prompt + (size_t)row * D : p.x_sample + (size_t)(row - MP) * D) : yrow;
        f32x4 v[4]; float s = 0.f;
#pragma unroll
        for (int j = 0; j < 4; ++j) { v[j] = ((const f32x4*)xin)[lane + 64 * j]; s += (v[j][0] + v[j][1]) + (v[j][2] + v[j][3]); }
        const float mean = wave_sum(s) * (1.f / D); float s2 = 0.f;
#pragma unroll
        for (int j = 0; j < 4; ++j) { v[j] = v[j] - mean; s2 += (v[j][0] * v[j][0] + v[j][1] * v[j][1]) + (v[j][2] * v[j][2] + v[j][3] * v[j][3]); }
        const float rstd = 1.f / sqrtf(wave_sum(s2) * (1.f / D) + LN_EPS);
        const float* mrow = mod + (size_t)bidx_of_row(row) * 6144 + (MODE == 0 ? 0 : 3072);
#pragma unroll
        for (int j = 0; j < 4; ++j) { const f32x4 o = v[j] * rstd * gv[j] + bv[j]; ((f32x4*)yrow)[lane + 64 * j] = o;
            if (MODE != 2) { const f32x4 sh = ((const f32x4*)mrow)[lane + 64 * j], sc = ((const f32x4*)(mrow + D))[lane + 64 * j]; const f32x4 h = o * (sc + 1.0f) + sh;
                u32x2 w; w.x = cvt_pk_bf16(h[0], h[1]); w.y = cvt_pk_bf16(h[2], h[3]); ((u32x2*)(H + (size_t)row * D))[lane + 64 * j] = w; } }
    }
}

#define MFMA16(a, b, c) __builtin_amdgcn_mfma_f32_16x16x32_bf16(a, b, c, 0, 0, 0)
template <int C>
__device__ __forceinline__ void stage_vT(const bf16_t* src, LAS bf16_t* vT, int lane, int wave) {
    constexpr int CP = C + 8;
#pragma unroll
    for (int i = 0; i < C / 32; ++i) { const int t = (lane >> 4) + 4 * wave + 32 * i, eg = lane & 15; const u32x4 v = *(const u32x4*)(src + (size_t)t * PP + eg * 8);
#pragma unroll
        for (int ii = 0; ii < 4; ++ii) { vT[(eg * 8 + 2 * ii) * CP + t] = (bf16_t)(v[ii] & 0xffffu); vT[(eg * 8 + 2 * ii + 1) * CP + t] = (bf16_t)(v[ii] >> 16); } }
}
template <int C>
__device__ __forceinline__ void gla_local(const Params& p, LAS unsigned char* lds, int row0, int h, int slot, bool sample, int sb) {
    constexpr int TS = C / 8, CP = C + 8;
    const int tid = threadIdx.x, lane = tid & 63, wave = __builtin_amdgcn_readfirstlane(tid >> 6), fr = lane & 15, fq = lane >> 4;
    LAS float* tot = (LAS float*)lds;
    LAS float* dvl = tot + 512;
    LAS bf16_t* KhT = (LAS bf16_t*)(lds + 4096);
    LAS bf16_t* vT = KhT + 64 * CP;
    bf16_t* P = (bf16_t*)(p.ws + WS_P);
    const float* glr = (const float*)(p.ws + WS_GLR);
    float* AS = (float*)(p.ws + WS_AS);
    const int d = lane;
    float w2[16];
#pragma unroll
    for (int r = 0; r < 16; ++r) w2[r] = p.w_gate2[r * 256 + h * 64 + d];
    const float b2 = p.b_gate2[h * 64 + d];
    float bl[TS]; float run = 0.f;
#pragma unroll
    for (int i = 0; i < TS; ++i) { const float* g = glr + (size_t)(row0 + wave * TS + i) * 16; float z = b2;
#pragma unroll
        for (int r = 0; r < 16; ++r) z += g[r] * w2[r];
        const float ls = fminf(z, 0.f) - log1pf(expf(-fabsf(z))); run += ls * (1.0f / 16.0f); bl[i] = run; }
    tot[wave * 64 + d] = run;
    __syncthreads();
    float off = 0.f, blast = 0.f;
#pragma unroll
    for (int s = 0; s < 8; ++s) { const float tv = tot[s * 64 + d]; blast += tv; off += (s < wave) ? tv : 0.f; }
    float kh[TS];
#pragma unroll
    for (int i = 0; i < TS; ++i) { const size_t a = (size_t)(row0 + wave * TS + i) * PP + h * 64 + d; const float b = bl[i] + off; const float q = bf2f(P[a]), k = bf2f(P[a + 256]);
        P[a] = f2bf(q * expf(b)); P[a + 256] = f2bf(k * expf(-b)); kh[i] = k * expf(blast - b); }
    if (TS == 8) { u32x4 w; w.x = cvt_pk_bf16(kh[0], kh[1]); w.y = cvt_pk_bf16(kh[2], kh[3]); w.z = cvt_pk_bf16(kh[4 % TS], kh[5 % TS]); w.w = cvt_pk_bf16(kh[6 % TS], kh[7 % TS]); *(LAS u32x4*)(KhT + d * CP + wave * 8) = w; }
    else { u32x2 w; w.x = cvt_pk_bf16(kh[0], kh[1]); w.y = cvt_pk_bf16(kh[2], kh[3]); *(LAS u32x2*)(KhT + d * CP + wave * 4) = w; }
    if (wave == 0) { const float dv = expf(blast); dvl[d] = dv; ((float*)(p.ws + WS_DVEC))[slot * 64 + d] = dv; }
    stage_vT<C>(P + (size_t)row0 * PP + 512 + h * 128, vT, lane, wave);
    __syncthreads();
    f32x4 acc[4];
#pragma unroll
    for (int di = 0; di < 4; ++di) acc[di] = (f32x4){0.f, 0.f, 0.f, 0.f};
#pragma unroll
    for (int ks = 0; ks < C / 32; ++ks) { const bf16x8 a = *(const LAS bf16x8*)(vT + (16 * wave + fr) * CP + 32 * ks + 8 * fq);
#pragma unroll
        for (int di = 0; di < 4; ++di) { const bf16x8 b = *(const LAS bf16x8*)(KhT + (16 * di + fr) * CP + 32 * ks + 8 * fq); acc[di] = MFMA16(a, b, acc[di]); } }
    const int e0 = 16 * wave + 4 * fq;
    if (!sample) {
#pragma unroll
        for (int di = 0; di < 4; ++di)
#pragma unroll
            for (int r = 0; r < 4; ++r) AS[(size_t)slot * 8192 + (e0 + r) * 64 + 16 * di + fr] = acc[di][r];
    } else {
#pragma unroll
        for (int di = 0; di < 4; ++di) { const int dd = 16 * di + fr; const size_t so = ((size_t)sb * 64 + dd) * 128 + e0; const f32x4 s0 = *(const f32x4*)(p.state_gla + so); const float dv = dvl[dd];
            *(f32x4*)(p.out + OUT_SS + so) = s0 * dv + acc[di];
#pragma unroll
            for (int r = 0; r < 4; ++r) AS[(size_t)slot * 8192 + (e0 + r) * 64 + dd] = s0[r]; }
    }
    __syncthreads();
}
template <int C>
__device__ __forceinline__ void gla_out(const Params& p, LAS unsigned char* lds, int row0, int h, int slot) {
    constexpr int CP = C + 8, NT = C / 16;
    const int tid = threadIdx.x, lane = tid & 63, wave = __builtin_amdgcn_readfirstlane(tid >> 6), fr = lane & 15, fq = lane >> 4;
    LAS bf16_t* Qs = (LAS bf16_t*)lds;
    LAS bf16_t* Ks = Qs + C * 72;
    LAS bf16_t* STs = Ks + C * 72;
    LAS bf16_t* vT = STs + 128 * 72;
    LAS bf16_t* att = vT + 128 * CP;
    LAS float* rs = (LAS float*)(att + C * CP);
    const bf16_t* P = (const bf16_t*)(p.ws + WS_P);
    const float* AS = (const float*)(p.ws + WS_AS);
    bf16_t* mix = (bf16_t*)(p.ws + WS_MIX);
    if (tid < C * 8) { const int t = tid >> 3, pc = tid & 7; const bf16_t* src = P + (size_t)(row0 + t) * PP + h * 64 + pc * 8;
        *(LAS u32x4*)(Qs + t * 72 + pc * 8) = *(const u32x4*)src; *(LAS u32x4*)(Ks + t * 72 + pc * 8) = *(const u32x4*)(src + 256); }
    { const int e = tid >> 2, dq = (tid & 3) * 16; const f32x4* s = (const f32x4*)(AS + (size_t)slot * 8192 + e * 64 + dq); const f32x4 a = s[0], b = s[1], c = s[2], d4 = s[3];
        u32x4 w0, w1; w0.x = cvt_pk_bf16(a[0], a[1]); w0.y = cvt_pk_bf16(a[2], a[3]); w0.z = cvt_pk_bf16(b[0], b[1]); w0.w = cvt_pk_bf16(b[2], b[3]);
        w1.x = cvt_pk_bf16(c[0], c[1]); w1.y = cvt_pk_bf16(c[2], c[3]); w1.z = cvt_pk_bf16(d4[0], d4[1]); w1.w = cvt_pk_bf16(d4[2], d4[3]);
        *(LAS u32x4*)(STs + e * 72 + dq) = w0; *(LAS u32x4*)(STs + e * 72 + dq + 8) = w1; }
    stage_vT<C>(P + (size_t)row0 * PP + 512 + h * 128, vT, lane, wave);
    __syncthreads();
    for (int tt = wave; tt < NT * NT; tt += 8) { const int it = tt / NT, jt = tt % NT; const int i = 16 * it + fr, j0 = 16 * jt + 4 * fq;
        u32x2 w; w.x = 0u; w.y = 0u;
        if (jt <= it) { f32x4 s = (f32x4){0.f, 0.f, 0.f, 0.f};
#pragma unroll
            for (int ks = 0; ks < 2; ++ks) { const bf16x8 a = *(const LAS bf16x8*)(Ks + (16 * jt + fr) * 72 + 32 * ks + 8 * fq), b = *(const LAS bf16x8*)(Qs + (16 * it + fr) * 72 + 32 * ks + 8 * fq); s = MFMA16(a, b, s); }
#pragma unroll
            for (int r = 0; r < 4; ++r) s[r] = (j0 + r <= i) ? s[r] : 0.f;
            w.x = cvt_pk_bf16(s[0], s[1]); w.y = cvt_pk_bf16(s[2], s[3]); }
        *(LAS u32x2*)(att + i * CP + j0) = w; }
    __syncthreads();
    f32x4 o[NT]; bf16x8 sa[2], va[C / 32];
#pragma unroll
    for (int ks = 0; ks < 2; ++ks) sa[ks] = *(const LAS bf16x8*)(STs + (16 * wave + fr) * 72 + 32 * ks + 8 * fq);
#pragma unroll
    for (int ks = 0; ks < C / 32; ++ks) va[ks] = *(const LAS bf16x8*)(vT + (16 * wave + fr) * CP + 32 * ks + 8 * fq);
#pragma unroll
    for (int it = 0; it < NT; ++it) { o[it] = (f32x4){0.f, 0.f, 0.f, 0.f};
#pragma unroll
        for (int ks = 0; ks < 2; ++ks) { const bf16x8 b = *(const LAS bf16x8*)(Qs + (16 * it + fr) * 72 + 32 * ks + 8 * fq); o[it] = MFMA16(sa[ks], b, o[it]); }
#pragma unroll
        for (int ks = 0; ks < C / 32; ++ks) if (2 * ks <= it) { const bf16x8 b = *(const LAS bf16x8*)(att + (16 * it + fr) * CP + 32 * ks + 8 * fq); o[it] = MFMA16(va[ks], b, o[it]); } }
#pragma unroll
    for (int it = 0; it < NT; ++it) { float ss = (o[it][0] * o[it][0] + o[it][1] * o[it][1]) + (o[it][2] * o[it][2] + o[it][3] * o[it][3]); ss += __shfl_xor(ss, 16); ss += __shfl_xor(ss, 32);
        if (fq == 0) rs[(16 * it + fr) * 8 + wave] = ss; }
    __syncthreads();
    const int e0 = 16 * wave + 4 * fq; const f32x4 gn = *(const f32x4*)(p.gla_norm_g + e0);
#pragma unroll
    for (int it = 0; it < NT; ++it) { const int i = 16 * it + fr; const f32x4 r0 = *(const LAS f32x4*)(rs + i * 8), r1 = *(const LAS f32x4*)(rs + i * 8 + 4);
        const float totv = ((r0[0] + r0[1]) + (r0[2] + r0[3])) + ((r1[0] + r1[1]) + (r1[2] + r1[3])); const float rinv = 1.0f / sqrtf(totv * (1.0f / 128.0f) + RMS_EPS);
        const u32x2 rr = *(const u32x2*)(P + (size_t)(row0 + i) * PP + 1024 + h * 128 + e0);
        const f32x4 ov = o[it] * rinv * gn; u32x2 w; w.x = cvt_pk_bf16(ov[0] * bflo(rr.x), ov[1] * bfhi(rr.x)); w.y = cvt_pk_bf16(ov[2] * bflo(rr.y), ov[3] * bfhi(rr.y));
        *(u32x2*)(mix + (size_t)(row0 + i) * D + h * 128 + e0) = w; }
    __syncthreads();
}
template <int L>
__device__ __forceinline__ void gmlp_item(const Params& p, LAS unsigned char* lds, int row0, int g, bool sample, int sbatch) {
    constexpr int LP = L + 8, NT = L / 16, TPW = L / 8;
    const int tid = threadIdx.x, lane = tid & 63, wave = __builtin_amdgcn_readfirstlane(tid >> 6), fr = lane & 15, fq = lane >> 4;
    LAS float* st = (LAS float*)lds;
    LAS bf16_t* zT = (LAS bf16_t*)(lds + 1024);
    LAS bf16_t* wsl = zT + 128 * LP;
    const bf16_t* P = (const bf16_t*)(p.ws + WS_P);
    bf16_t* mix = (bf16_t*)(p.ws + WS_MIX);
#pragma unroll 4
    for (int tt = 0; tt < TPW; ++tt) { const int t = wave * TPW + tt; const u32x4 v = *(const u32x4*)(P + (size_t)(row0 + t) * PP + 2048 + lane * 8);
        float s = 0.f, ss = 0.f;
#pragma unroll
        for (int ii = 0; ii < 4; ++ii) { const float a = bflo(v[ii]), b = bfhi(v[ii]); s += a + b; ss += a * a + b * b; }
        s = wave_sum(s); ss = wave_sum(ss);
        const float mean = s * (1.0f / 512.0f), var = fmaxf(ss * (1.0f / 512.0f) - mean * mean, 0.f);
        if (lane == 0) { st[2 * t] = mean; st[2 * t + 1] = 1.0f / sqrtf(var + LN_EPS); } }
    for (int idx = tid; idx < L * L / 2; idx += 512) { const int i = idx / (L / 2), j = (idx % (L / 2)) * 2; const f32x2 w = *(const f32x2*)(p.w_spatial + (size_t)g * 16384 + i * 128 + j);
        *(LAS unsigned*)(wsl + i * LP + j) = cvt_pk_bf16(j <= i ? w[0] : 0.f, j + 1 <= i ? w[1] : 0.f); }
    __syncthreads();
#pragma unroll
    for (int ii = 0; ii < L / 32; ++ii) { const int t = (lane >> 4) + 4 * wave + 32 * ii, c8 = lane & 15, col = g * 128 + c8 * 8;
        const u32x4 v = *(const u32x4*)(P + (size_t)(row0 + t) * PP + 2048 + col); const float mean = st[2 * t], rstd = st[2 * t + 1];
        const f32x4 g0 = *(const f32x4*)(p.gmlp_ln_g + col), g1 = *(const f32x4*)(p.gmlp_ln_g + col + 4), b0 = *(const f32x4*)(p.gmlp_ln_b + col), b1 = *(const f32x4*)(p.gmlp_ln_b + col + 4);
        f32x4 y0, y1;
        y0[0] = (bflo(v[0]) - mean) * rstd * g0[0] + b0[0]; y0[1] = (bfhi(v[0]) - mean) * rstd * g0[1] + b0[1]; y0[2] = (bflo(v[1]) - mean) * rstd * g0[2] + b0[2]; y0[3] = (bfhi(v[1]) - mean) * rstd * g0[3] + b0[3];
        y1[0] = (bflo(v[2]) - mean) * rstd * g1[0] + b1[0]; y1[1] = (bfhi(v[2]) - mean) * rstd * g1[1] + b1[1]; y1[2] = (bflo(v[3]) - mean) * rstd * g1[2] + b1[2]; y1[3] = (bfhi(v[3]) - mean) * rstd * g1[3] + b1[3];
#pragma unroll
        for (int k = 0; k < 4; ++k) { zT[(c8 * 8 + k) * LP + t] = f2bf(y0[k]); zT[(c8 * 8 + 4 + k) * LP + t] = f2bf(y1[k]); }
        if (sample) { float* o = p.out + OUT_V + ((size_t)(sbatch * 32 + t) * 512 + col); *(f32x4*)o = y0; *(f32x4*)(o + 4) = y1; } }
    __syncthreads();
    f32x4 acc[NT]; bf16x8 za[L / 32];
#pragma unroll
    for (int ks = 0; ks < L / 32; ++ks) za[ks] = *(const LAS bf16x8*)(zT + (16 * wave + fr) * LP + 32 * ks + 8 * fq);
#pragma unroll
    for (int it = 0; it < NT; ++it) { acc[it] = (f32x4){0.f, 0.f, 0.f, 0.f};
#pragma unroll
        for (int ks = 0; ks < L / 32; ++ks) if (2 * ks <= it) { const bf16x8 b = *(const LAS bf16x8*)(wsl + (16 * it + fr) * LP + 32 * ks + 8 * fq); acc[it] = MFMA16(za[ks], b, acc[it]); } }
    const int c0 = 16 * wave + 4 * fq;
#pragma unroll
    for (int it = 0; it < NT; ++it) { const int i = 16 * it + fr; const float bsp = p.b_spatial[g * 128 + i]; const u32x2 zu = *(const u32x2*)(P + (size_t)(row0 + i) * PP + 1536 + g * 128 + c0);
        u32x2 w; w.x = cvt_pk_bf16(bflo(zu.x) * (acc[it][0] + bsp), bfhi(zu.x) * (acc[it][1] + bsp)); w.y = cvt_pk_bf16(bflo(zu.y) * (acc[it][2] + bsp), bfhi(zu.y) * (acc[it][3] + bsp));
        *(u32x2*)(mix + (size_t)(row0 + i) * D + 512 + g * 128 + c0) = w; }
    __syncthreads();
}
__device__ __forceinline__ void phase3(const Params& p, LAS unsigned char* lds) {
    for (int it = blockIdx.x; it < 1792; it += gridDim.x) {
        if (it < 512) { const int b = it >> 8, m = (it >> 2) & 63, g = it & 3; gmlp_item<128>(p, lds, b * SEQ + m * 128, g, false, 0); }
        else if (it < 1536) { const int s = it - 512, bh = s >> 7, c = s & 127; gla_local<64>(p, lds, (bh >> 2) * SEQ + c * 64, bh & 3, s, false, 0); }
        else if (it < 1664) { const int s = it - 1536, b = s >> 2, h = s & 3; gla_local<32>(p, lds, MP + b * 32, h, 1024 + s, true, s); }
        else { const int s = it - 1664, b = s >> 2, g = s & 3; gmlp_item<32>(p, lds, MP + b * 32, g, true, b); }
    }
}
__device__ __forceinline__ void phase4(const Params& p) {
    const int tid = threadIdx.x; if (tid >= 256) return;
    float* AS = (float*)(p.ws + WS_AS); const float* dvec = (const float*)(p.ws + WS_DVEC);
    for (int gt = blockIdx.x * 256 + tid; gt < 65536; gt += gridDim.x * 256) {
        const int bh = gt >> 13, idx = gt & 8191, d = idx & 63, e = idx >> 6;
        float S = 0.f;
        for (int c0 = 0; c0 < 128; c0 += 16) { float a[16], dv[16];
#pragma unroll
            for (int i = 0; i < 16; ++i) { a[i] = AS[(size_t)(bh * 128 + c0 + i) * 8192 + idx]; dv[i] = dvec[(bh * 128 + c0 + i) * 64 + d]; }
#pragma unroll
            for (int i = 0; i < 16; ++i) { AS[(size_t)(bh * 128 + c0 + i) * 8192 + idx] = S; S = dv[i] * S + a[i]; } }
        p.out[OUT_SP + ((size_t)bh * 64 + d) * 128 + e] = S;
    }
}
__device__ __forceinline__ void phase5(const Params& p, LAS unsigned char* lds) {
    for (int it = blockIdx.x; it < 1152; it += gridDim.x) {
        if (it < 1024) { const int bh = it >> 7, c = it & 127; gla_out<64>(p, lds, (bh >> 2) * SEQ + c * 64, bh & 3, it); }
        else { const int s = it - 1024, b = s >> 2, h = s & 3; gla_out<32>(p, lds, MP + b * 32, h, it); }
    }
}

template <bool COOP>
__global__ void __launch_bounds__(512, 2) k_fwd(Params p) {
    extern __shared__ __attribute__((aligned(16))) unsigned char lds_raw[];
    LAS unsigned char* lds = (LAS unsigned char*)lds_raw;
    const int lo = p.lo, hi = p.hi;
#define IN(k) (lo <= (k) && (k) < hi)
#define SEAM(k) do { if (COOP && IN(k) && IN((k) + 1)) { cg::this_grid().sync(); } } while (0)
    unsigned char* ws = p.ws;
    const float* mod = (const float*)(ws + WS_MOD);
    if (IN(0)) { phase0(p, lds); } SEAM(0);
    if (IN(1)) { ln_phase<0>(p); } SEAM(1);
    if (IN(2)) { pg8::Gemm g{(const bf16_t*)(ws + WS_H), (const bf16_t*)(ws + WS_WIN), MTOT, NPROJ, D}; pg8::StaticOrder S; S.init(MTOT, NPROJ, gridDim.x, blockIdx.x);
        EpiProj E{(bf16_t*)(ws + WS_P), (float*)(ws + WS_GLR)}; pg8::gemm_phase<EpiProj>(lds, g, S, E); } SEAM(2);
    if (IN(3)) { phase3(p, lds); } SEAM(3);
    if (IN(4)) { phase4(p); } SEAM(4);
    if (IN(5)) { phase5(p, lds); } SEAM(5);
    if (IN(6)) { pg8::Gemm g{(const bf16_t*)(ws + WS_MIX), (const bf16_t*)(ws + WS_WO), MTOT, D, D}; pg8::StaticOrder S; S.init(MTOT, D, gridDim.x, blockIdx.x);
        EpiRes E{p.out + OUT_Y, p.b_o, mod + 2048}; pg8::gemm_phase<EpiRes>(lds, g, S, E); } SEAM(6);
    if (IN(7)) { ln_phase<1>(p); } SEAM(7);
    if (IN(8)) { pg8::Gemm g{(const bf16_t*)(ws + WS_H), (const bf16_t*)(ws + WS_WUP), MTOT, FF, D}; pg8::StaticOrder S; S.init(MTOT, FF, gridDim.x, blockIdx.x);
        EpiUp E{(bf16_t*)(ws + WS_U), p.b_up}; pg8::gemm_phase<EpiUp>(lds, g, S, E); } SEAM(8);
    if (IN(9)) { pg8::Gemm g{(const bf16_t*)(ws + WS_U), (const bf16_t*)(ws + WS_WDN), MTOT, D, FF}; pg8::StaticOrder S; S.init(MTOT, D, gridDim.x, blockIdx.x);
        EpiRes E{p.out + OUT_Y, p.b_down, mod + 5120}; pg8::gemm_phase<EpiRes>(lds, g, S, E); } SEAM(9);
    if (IN(10)) { ln_phase<2>(p); }
#undef IN
#undef SEAM
}

extern "C" void kernel_launch(void* const* d_in, const int* in_sizes, int n_in, void* d_out, int out_size, void* d_ws, size_t ws_size, hipStream_t stream) {
    static int grid = 0;
    if (grid == 0) {
        int dev = 0, cus = 0, per_cu = 0;
        hipGetDevice(&dev); hipDeviceGetAttribute(&cus, hipDeviceAttributeMultiprocessorCount, dev);
        hipFuncSetAttribute((const void*)k_fwd<true>, hipFuncAttributeMaxDynamicSharedMemorySize, LDS_BYTES);
        hipFuncSetAttribute((const void*)k_fwd<false>, hipFuncAttributeMaxDynamicSharedMemorySize, LDS_BYTES);
        hipOccupancyMaxActiveBlocksPerMultiprocessor(&per_cu, (const void*)k_fwd<true>, 512, LDS_BYTES);
        if (per_cu < 1) { fprintf(stderr, "kernel_launch: occupancy query says %d blocks per CU\n", per_cu); per_cu = 1; }
        grid = cus * per_cu;
        (void)hipGetLastError();
        if (n_in != 27 || ws_size < WS_END) fprintf(stderr, "kernel_launch: unexpected n_in %d or ws_size %zu\n", n_in, ws_size);
    }
    Params p{};
    const float** pp = (const float**)&p;
    for (int i = 0; i < 27; ++i) pp[i] = (const float*)d_in[i];
    p.out = (float*)d_out; p.ws = (unsigned char*)d_ws;
#if MULTI_LAUNCH
    for (int ph = 0; ph < NPHASE; ++ph) { p.lo = ph; p.hi = ph + 1; hipLaunchKernelGGL(k_fwd<false>, dim3(grid), dim3(512), LDS_BYTES, stream, p); }
#else
    p.lo = 0; p.hi = NPHASE;
    void* args[] = {&p};
    hipError_t e = hipLaunchCooperativeKernel((const void*)k_fwd<true>, dim3(grid), dim3(512), args, LDS_BYTES, stream);
    if (e != hipSuccess) fprintf(stderr, "cooperative launch failed: %s (grid %d)\n", hipGetErrorString(e), grid);
#endif
}
```
